# Optimizing an MI355X kernel written in HIP

```python
import jax, jax.numpy as jnp
from jax import lax
import numpy as np

D_MODEL = 1024
BATCH = 8
SEQ = 2048
DEPTH = 1

PLE_DIM = 256
LRU_WIDTH = D_MODEL
LRU_BLOCKS = 8
LRU_BLOCK = LRU_WIDTH // LRU_BLOCKS
CONV_WIDTH = 4
LRU_C = 8.0
LRU_A_MIN = 0.9
LRU_A_MAX = 0.999
GLA_HEADS = 4
GLA_DK = D_MODEL // 2 // GLA_HEADS
GLA_DV = D_MODEL // GLA_HEADS
GLA_RANK = 16
GLA_TAU = 16.0
GLA_CHUNK = 64
N_EXPERTS = 32
TOP_K = 4
D_FF = D_MODEL
SWIGLU_LIMIT = 7.0
SWIGLU_ALPHA = 1.702
MOE_BLOCK = 128
LN_EPS = 1e-5
RMS_EPS = 1e-5
DEEPNORM_ALPHA = (2.0 * DEPTH) ** 0.25
DEEPNORM_BETA = (8.0 * DEPTH) ** -0.25

IN_WIDTHS = [LRU_WIDTH, LRU_WIDTH, GLA_HEADS * GLA_DK, GLA_HEADS * GLA_DK,
             GLA_HEADS * GLA_DV, GLA_HEADS * GLA_DV, GLA_RANK, D_MODEL, D_MODEL]
IN_TOTAL = int(sum(IN_WIDTHS))
IN_SPLITS = [int(s) for s in np.cumsum(IN_WIDTHS)[:-1]]

kernel_name = "hybrid_rglru_gla_moe_deepnorm_ple"


def layer_norm(x, g, b):
    xf = x.astype(jnp.float32)
    mu = jnp.mean(xf, axis=-1, keepdims=True)
    var = jnp.mean(jnp.square(xf - mu), axis=-1, keepdims=True)
    return ((xf - mu) * lax.rsqrt(var + LN_EPS) * g + b).astype(x.dtype)


def causal_depthwise_conv(x, w, b):
    s = x.shape[1]
    xp = jnp.pad(x, ((0, 0), (CONV_WIDTH - 1, 0), (0, 0)))
    out = xp[:, 0:s] * w[0]
    for k in range(1, CONV_WIDTH):
        out = out + xp[:, k:k + s] * w[k]
    return out + b


def rg_lru(x, w_r, b_r, w_i, b_i, lam):
    bsz, s, c = x.shape
    xb = x.reshape(bsz, s, LRU_BLOCKS, LRU_BLOCK)
    r = jax.nn.sigmoid(jnp.einsum('bsgc,gcd->bsgd', xb, w_r).reshape(bsz, s, c) + b_r)
    i = jax.nn.sigmoid(jnp.einsum('bsgc,gcd->bsgd', xb, w_i).reshape(bsz, s, c) + b_i)
    log_a = (-LRU_C * r * jax.nn.softplus(-lam)).astype(jnp.float32)
    a = jnp.exp(log_a)
    mult = jnp.sqrt(-jnp.expm1(2.0 * log_a))
    u = mult * (i * x).astype(jnp.float32)

    def combine(left, right):
        a1, b1 = left
        a2, b2 = right
        return a1 * a2, a2 * b1 + b2

    _, h = lax.associative_scan(combine, (a, u), axis=1)
    return h.astype(x.dtype)


def gla_chunked(q, k, v, log_g):
    bsz, s, h, dk = q.shape
    dv = v.shape[-1]
    n = s // GLA_CHUNK

    def to_chunks(t):
        t = t.astype(jnp.float32).reshape(bsz, n, GLA_CHUNK, h, t.shape[-1])
        return t.transpose(1, 0, 3, 2, 4)

    qc = to_chunks(q * (dk ** -0.5))
    kc, vc, gc = to_chunks(k), to_chunks(v), to_chunks(log_g)
    causal = jnp.tril(jnp.ones((GLA_CHUNK, GLA_CHUNK), dtype=bool))

    def step(state, inp):
        qn, kn, vn, gn = inp
        bcum = jnp.cumsum(gn, axis=2)
        o_inter = jnp.einsum('bhik,bhkv->bhiv', qn * jnp.exp(bcum), state)
        diff = bcum[:, :, :, None, :] - bcum[:, :, None, :, :]
        decay = jnp.exp(jnp.where(causal[:, :, None], diff, -jnp.inf))
        scores = jnp.einsum('bhijk,bhjk->bhij', qn[:, :, :, None, :] * decay, kn)
        o_intra = jnp.einsum('bhij,bhjv->bhiv', scores, vn)
        b_last = bcum[:, :, -1:, :]
        k_dec = kn * jnp.exp(b_last - bcum)
        state = (jnp.exp(b_last[:, :, 0, :])[..., None] * state
                 + jnp.einsum('bhjk,bhjv->bhkv', k_dec, vn))
        return state, o_inter + o_intra

    state0 = jnp.zeros((bsz, h, dk, dv), jnp.float32)
    _, o = lax.scan(step, state0, (qc, kc, vc, gc))
    o = o.transpose(1, 0, 3, 2, 4).reshape(bsz, s, h, dv)
    return o


def moe(x, w_router, b_router, w_up, b_up, w_down, b_down):
    bsz, s, d = x.shape
    t = bsz * s
    xt = x.reshape(t, d)
    logits = (xt @ w_router + b_router).astype(jnp.float32)
    top_val, top_idx = lax.top_k(logits, TOP_K)
    gates = jax.nn.softmax(top_val, axis=-1).astype(x.dtype)

    n_assign = t * TOP_K
    expert_flat = top_idx.reshape(n_assign)
    token_flat = (jnp.arange(n_assign, dtype=jnp.int32) // TOP_K).astype(jnp.int32)
    gate_flat = gates.reshape(n_assign)
    order = jnp.argsort(expert_flat)
    sorted_expert = expert_flat[order]
    counts = jnp.bincount(expert_flat, length=N_EXPERTS)
    start = jnp.cumsum(counts) - counts
    padded_counts = (counts + MOE_BLOCK - 1) // MOE_BLOCK * MOE_BLOCK
    padded_end = jnp.cumsum(padded_counts)
    padded_start = padded_end - padded_counts
    slot = padded_start[sorted_expert] + jnp.arange(n_assign) - start[sorted_expert]

    n_slots = n_assign + N_EXPERTS * MOE_BLOCK
    n_blocks = n_slots // MOE_BLOCK
    slot_token = jnp.full((n_slots,), t, jnp.int32).at[slot].set(token_flat[order])
    slot_gate = jnp.zeros((n_slots,), x.dtype).at[slot].set(gate_flat[order])
    block_expert = jnp.minimum(
        jnp.searchsorted(padded_end, jnp.arange(n_blocks) * MOE_BLOCK, side='right'),
        N_EXPERTS - 1)
    x_pad = jnp.concatenate([xt, jnp.zeros((1, d), xt.dtype)], axis=0)

    def expert_block(args):
        tok, g, e = args
        xb = x_pad[tok]
        hdn = xb @ w_up[e] + b_up[e]
        gate_h = jnp.minimum(hdn[:, :D_FF], SWIGLU_LIMIT)
        up_h = jnp.clip(hdn[:, D_FF:], -SWIGLU_LIMIT, SWIGLU_LIMIT)
        act = (up_h + 1.0) * gate_h * jax.nn.sigmoid(SWIGLU_ALPHA * gate_h)
        y = act @ w_down[e] + b_down[e]
        return y * g[:, None]

    y_slots = lax.map(expert_block, (slot_token.reshape(n_blocks, MOE_BLOCK),
                                     slot_gate.reshape(n_blocks, MOE_BLOCK),
                                     block_expert))
    out = jnp.zeros((t + 1, d), y_slots.dtype).at[slot_token].add(y_slots.reshape(n_slots, d))
    return out[:t].reshape(bsz, s, d)


def setup_inputs(seed: int = 0) -> dict:
    key = jax.random.key(seed)
    ks = jax.random.split(key, 27)
    f32 = jnp.float32
    L = DEPTH

    def nrm(k, shape, scale):
        return jax.random.normal(k, shape, f32) * scale

    u = jax.random.uniform(ks[9], (L, LRU_WIDTH), f32, LRU_A_MIN, LRU_A_MAX)
    s_base = u ** (1.0 / LRU_C)
    lru_lambda = jnp.log(s_base) - jnp.log1p(-s_base)
    return {
        "x": nrm(ks[0], (BATCH, SEQ, D_MODEL), 1.0),
        "p": nrm(ks[1], (DEPTH, BATCH, SEQ, PLE_DIM), 1.0),
        "w_in": nrm(ks[2], (L, D_MODEL, IN_TOTAL), D_MODEL ** -0.5),
        "conv_w": nrm(ks[3], (L, CONV_WIDTH, LRU_WIDTH), CONV_WIDTH ** -0.5),
        "conv_b": nrm(ks[4], (L, LRU_WIDTH), 0.01),
        "lru_w_r": nrm(ks[5], (L, LRU_BLOCKS, LRU_BLOCK, LRU_BLOCK), LRU_BLOCK ** -0.5),
        "lru_b_r": nrm(ks[6], (L, LRU_WIDTH), 0.01),
        "lru_w_i": nrm(ks[7], (L, LRU_BLOCKS, LRU_BLOCK, LRU_BLOCK), LRU_BLOCK ** -0.5),
        "lru_b_i": nrm(ks[8], (L, LRU_WIDTH), 0.01),
        "lru_lambda": lru_lambda,
        "gla_w_gate": nrm(ks[10], (L, GLA_RANK, GLA_HEADS * GLA_DK), GLA_RANK ** -0.5),
        "gla_b_gate": nrm(ks[11], (L, GLA_HEADS * GLA_DK), 0.01),
        "gla_norm_g": 1.0 + nrm(ks[12], (L, GLA_DV), 0.02),
        "w_out": nrm(ks[13], (L, D_MODEL, D_MODEL), DEEPNORM_BETA * D_MODEL ** -0.5),
        "ln1_g": 1.0 + nrm(ks[14], (L, D_MODEL), 0.02),
        "ln1_b": nrm(ks[15], (L, D_MODEL), 0.01),
        "w_router": nrm(ks[16], (L, D_MODEL, N_EXPERTS), D_MODEL ** -0.5),
        "b_router": nrm(ks[17], (L, N_EXPERTS), 0.01),
        "w_up": nrm(ks[18], (L, N_EXPERTS, D_MODEL, 2 * D_FF), D_MODEL ** -0.5),
        "b_up": nrm(ks[19], (L, N_EXPERTS, 2 * D_FF), 0.01),
        "w_down": nrm(ks[20], (L, N_EXPERTS, D_FF, D_MODEL), DEEPNORM_BETA * D_FF ** -0.5),
        "b_down": nrm(ks[21], (L, N_EXPERTS, D_MODEL), 0.01),
        "ln2_g": 1.0 + nrm(ks[22], (L, D_MODEL), 0.02),
        "ln2_b": nrm(ks[23], (L, D_MODEL), 0.01),
        "w_ple": nrm(ks[24], (L, PLE_DIM, D_MODEL), PLE_DIM ** -0.5),
        "w_ple_gate": nrm(ks[25], (L, D_MODEL, D_MODEL), D_MODEL ** -0.5),
        "b_ple_gate": nrm(ks[26], (L, D_MODEL), 0.01),
    }


def reference(x, p, w_in, conv_w, conv_b, lru_w_r, lru_b_r, lru_w_i, lru_b_i, lru_lambda,
              gla_w_gate, gla_b_gate, gla_norm_g, w_out, ln1_g, ln1_b,
              w_router, b_router, w_up, b_up, w_down, b_down, ln2_g, ln2_b,
              w_ple, w_ple_gate, b_ple_gate):
    bsz, s, d = x.shape
    h = x
    for i in range(DEPTH):
        proj = h @ w_in[i]
        xa, ga, q, k, v, go, glr, ma, mb = jnp.split(proj, IN_SPLITS, axis=-1)

        xa = causal_depthwise_conv(xa, conv_w[i], conv_b[i])
        ya = rg_lru(xa, lru_w_r[i], lru_b_r[i], lru_w_i[i], lru_b_i[i], lru_lambda[i])
        ya = ya * jax.nn.gelu(ga)

        log_g = jax.nn.log_sigmoid(glr @ gla_w_gate[i] + gla_b_gate[i]) / GLA_TAU
        o = gla_chunked(q.reshape(bsz, s, GLA_HEADS, GLA_DK),
                        k.reshape(bsz, s, GLA_HEADS, GLA_DK),
                        v.reshape(bsz, s, GLA_HEADS, GLA_DV),
                        log_g.reshape(bsz, s, GLA_HEADS, GLA_DK))
        o = o * lax.rsqrt(jnp.mean(jnp.square(o), axis=-1, keepdims=True) + RMS_EPS) * gla_norm_g[i]
        yb = o.reshape(bsz, s, GLA_HEADS * GLA_DV).astype(h.dtype) * jax.nn.silu(go)

        y = jax.nn.sigmoid(ma) * ya + jax.nn.sigmoid(mb) * yb
        h = layer_norm(DEEPNORM_ALPHA * h + y @ w_out[i], ln1_g[i], ln1_b[i])

        m = moe(h, w_router[i], b_router[i], w_up[i], b_up[i], w_down[i], b_down[i])
        h = layer_norm(DEEPNORM_ALPHA * h + m, ln2_g[i], ln2_b[i])

        h = h + jax.nn.sigmoid(h @ w_ple_gate[i] + b_ple_gate[i]) * (p[i] @ w_ple[i])
    return h
```

```cpp
#include <hip/hip_runtime.h>
#include <cstdint>
#include <cstdio>

constexpr int D = 1024, BATCH = 8, SEQ = 2048, T = BATCH * SEQ;
constexpr int PLE = 256, NE = 32, TOPK = 4, DFF = 1024;
constexpr int GH = 4, GDK = 128, GDV = 256, GRANK = 16, GCH = 64;
constexpr int INT = 7184;
constexpr int C_XA = 0, C_GA = 1024, C_Q = 2048, C_K = 2560, C_V = 3072, C_GO = 4096, C_GLR = 5120, C_MA = 5136, C_MB = 6160;
constexpr float ALPHA = 1.189207115002721f;

constexpr int TM = 64, TN = 64, TK = 16;
__device__ __forceinline__ void gemm_core(const float* __restrict__ A, int lda, const int* rowidx, int mvalid,
                                          const float* __restrict__ B, int ldb, int N, int K, int m0, int n0,
                                          float (&acc)[4][4], float (*As)[TM + 4], float (*Bs)[TN + 4]) {
    const int tid = threadIdx.x, tx = tid & 15, ty = tid >> 4;
    const int ar = tid >> 2, ak = (tid & 3) * 4;
    int arow = m0 + ar; if (arow >= mvalid) arow = m0;
    const int grow = rowidx ? rowidx[arow] : arow;
    const float* ap = A + (size_t)grow * lda + ak;
    const int bk = tid >> 4, bn = (tid & 15) * 4;
    const bool bok = (n0 + bn) < N;
    const float* bp = B + (size_t)bk * ldb + n0 + bn;
#pragma unroll
    for (int i = 0; i < 4; ++i)
#pragma unroll
        for (int j = 0; j < 4; ++j) acc[i][j] = 0.f;
    for (int k0 = 0; k0 < K; k0 += TK) {
        const float4 av = *(const float4*)(ap + k0);
        float4 bv = make_float4(0.f, 0.f, 0.f, 0.f);
        if (bok) bv = *(const float4*)(bp + (size_t)k0 * ldb);
        __syncthreads();
        As[ak + 0][ar] = av.x; As[ak + 1][ar] = av.y; As[ak + 2][ar] = av.z; As[ak + 3][ar] = av.w;
        *(float4*)&Bs[bk][bn] = bv;
        __syncthreads();
#pragma unroll
        for (int k = 0; k < TK; ++k) {
            const float4 a4 = *(const float4*)&As[k][ty * 4];
            const float4 b4 = *(const float4*)&Bs[k][tx * 4];
            const float a[4] = {a4.x, a4.y, a4.z, a4.w}, b[4] = {b4.x, b4.y, b4.z, b4.w};
#pragma unroll
            for (int i = 0; i < 4; ++i)
#pragma unroll
                for (int j = 0; j < 4; ++j) acc[i][j] = fmaf(a[i], b[j], acc[i][j]);
        }
    }
}

__global__ void __launch_bounds__(256) k_gemm(const float* A, int lda, const float* B, int ldb, float* C, int ldc, int M, int N, int K, const float* bias) {
    __shared__ float As[TK][TM + 4];
    __shared__ float Bs[TK][TN + 4];
    const int m0 = blockIdx.y * TM, n0 = blockIdx.x * TN;
    float acc[4][4];
    gemm_core(A, lda, nullptr, M, B, ldb, N, K, m0, n0, acc, As, Bs);
    const int tx = threadIdx.x & 15, ty = threadIdx.x >> 4;
#pragma unroll
    for (int i = 0; i < 4; ++i) {
        const int m = m0 + ty * 4 + i; if (m >= M) continue;
#pragma unroll
        for (int j = 0; j < 4; ++j) { const int n = n0 + tx * 4 + j; if (n < N) C[(size_t)m * ldc + n] = acc[i][j] + (bias ? bias[n] : 0.f); }
    }
}

__device__ __forceinline__ float sigmoidf_(float x) { return 1.f / (1.f + expf(-x)); }
__device__ __forceinline__ float softplusf_(float x) { return fmaxf(x, 0.f) + log1pf(expf(-fabsf(x))); }
__device__ __forceinline__ float gelu_tanh(float x) { const float c = 0.7978845608028654f; return 0.5f * x * (1.f + tanhf(c * (x + 0.044715f * x * x * x))); }

__global__ void k_conv(const float* proj, const float* cw, const float* cb, float* xc) {
    const size_t i = (size_t)blockIdx.x * blockDim.x + threadIdx.x; if (i >= (size_t)T * D) return;
    const int c = i % D; const int t = i / D; const int s = t % SEQ;
    float v = cb[c];
#pragma unroll
    for (int k = 0; k < 4; ++k) { const int ss = s - 3 + k; if (ss >= 0) v += cw[k * D + c] * proj[(size_t)(t - 3 + k) * INT + C_XA + c]; }
    xc[i] = v;
}
__global__ void k_scan(const float* proj, const float* xc, const float* rpre, const float* ipre, const float* br, const float* bi, const float* lam, float* ya) {
    const int i = blockIdx.x * blockDim.x + threadIdx.x; if (i >= BATCH * D) return;
    const int c = i % D, b = i / D;
    const float sp = softplusf_(-lam[c]);
    float h = 0.f;
    for (int s = 0; s < SEQ; ++s) {
        const size_t t = (size_t)b * SEQ + s;
        const float r = sigmoidf_(rpre[t * D + c] + br[c]), ig = sigmoidf_(ipre[t * D + c] + bi[c]);
        const float la = -8.f * r * sp; const float a = expf(la); const float mult = sqrtf(-expm1f(2.f * la));
        const float u = mult * (ig * xc[t * D + c]);
        h = a * h + u;
        ya[t * D + c] = h * gelu_tanh(proj[t * INT + C_GA + c]);
    }
}
__global__ void k_logg(const float* proj, const float* wg, const float* bg, float* G) {
    const int c = threadIdx.x; const int t0 = blockIdx.x * GCH;
    float w[GRANK];
#pragma unroll
    for (int r = 0; r < GRANK; ++r) w[r] = wg[r * 512 + c];
    const float bb = bg[c]; float cum = 0.f;
    for (int j = 0; j < GCH; ++j) {
        const float* g = proj + (size_t)(t0 + j) * INT + C_GLR; float z = bb;
#pragma unroll
        for (int r = 0; r < GRANK; ++r) z += g[r] * w[r];
        cum += -softplusf_(-z) * (1.f / 16.f);
        G[(size_t)(t0 + j) * 512 + c] = cum;
    }
}
constexpr int GW = 32;
__global__ void __launch_bounds__(256) k_gla(const float* proj, const float* G, float* o) {
    extern __shared__ float sm[];
    float* qs = sm;
    float* ks = qs + 64 * 129;
    float* vs = ks + 64 * 129;
    float* Ps = vs + 64 * GW;
    float* Ss = Ps + 64 * 65;
    float* eb = Ss + 128 * 33;
    const int tid = threadIdx.x;
    const int vsl = blockIdx.x % 8, h = (blockIdx.x / 8) % GH, b = blockIdx.x / 32;
    for (int i = tid; i < 128 * 33; i += 256) Ss[i] = 0.f;
    const float scale = 0.08838834764831845f;
    for (int n = 0; n < SEQ / GCH; ++n) {
        const size_t t0 = (size_t)b * SEQ + n * GCH;
        __syncthreads();
        for (int i = tid; i < 64 * 128; i += 256) { const int j = i >> 7, k = i & 127;
            const float bc = G[(t0 + j) * 512 + h * 128 + k];
            qs[j * 129 + k] = proj[(t0 + j) * INT + C_Q + h * 128 + k] * expf(bc) * scale;
            ks[j * 129 + k] = proj[(t0 + j) * INT + C_K + h * 128 + k] * expf(-bc); }
        for (int i = tid; i < 64 * GW; i += 256) { const int j = i / GW, v = i % GW; vs[i] = proj[(t0 + j) * INT + C_V + h * 256 + vsl * GW + v]; }
        if (tid < 128) eb[tid] = expf(G[(t0 + 63) * 512 + h * 128 + tid]);
        __syncthreads();
        { const int i = tid >> 2, j0 = (tid & 3) * 16;
          for (int jj = 0; jj < 16; ++jj) { const int j = j0 + jj; float s = 0.f;
              if (j <= i) { for (int k = 0; k < 128; ++k) s += qs[i * 129 + k] * ks[j * 129 + k]; }
              Ps[i * 65 + j] = s; } }
        __syncthreads();
        { const int i = tid >> 2, n0 = (tid & 3) * 8; float acc[8];
#pragma unroll
          for (int q = 0; q < 8; ++q) acc[q] = 0.f;
          for (int k = 0; k < 128; ++k) { const float a = qs[i * 129 + k];
#pragma unroll
              for (int q = 0; q < 8; ++q) acc[q] += a * Ss[k * 33 + n0 + q]; }
          for (int j = 0; j <= i; ++j) { const float a = Ps[i * 65 + j];
#pragma unroll
              for (int q = 0; q < 8; ++q) acc[q] += a * vs[j * GW + n0 + q]; }
#pragma unroll
          for (int q = 0; q < 8; ++q) o[(t0 + i) * D + h * 256 + vsl * GW + n0 + q] = acc[q]; }
        __syncthreads();
        { const int k = tid >> 1, n0 = (tid & 1) * 16; float acc[16];
#pragma unroll
          for (int q = 0; q < 16; ++q) acc[q] = Ss[k * 33 + n0 + q];
          for (int j = 0; j < 64; ++j) { const float a = ks[j * 129 + k];
#pragma unroll
              for (int q = 0; q < 16; ++q) acc[q] += a * vs[j * GW + n0 + q]; }
          const float e = eb[k];
#pragma unroll
          for (int q = 0; q < 16; ++q) Ss[k * 33 + n0 + q] = acc[q] * e; }
    }
}
__global__ void __launch_bounds__(256) k_ycomb(const float* proj, const float* ya, const float* o, const float* ng, float* y) {
    const int t = blockIdx.x, tid = threadIdx.x;
    float ov[4]; float ss = 0.f;
#pragma unroll
    for (int q = 0; q < 4; ++q) { ov[q] = o[(size_t)t * D + tid * 4 + q]; ss += ov[q] * ov[q]; }
#pragma unroll
    for (int m = 1; m < 64; m <<= 1) ss += __shfl_xor(ss, m);
    const float rs = rsqrtf(ss * (1.f / 256.f) + 1e-5f);
#pragma unroll
    for (int q = 0; q < 4; ++q) { const int c = tid * 4 + q; const float* pr = proj + (size_t)t * INT;
        const float go = pr[C_GO + c]; const float yb = ov[q] * rs * ng[c & 255] * (go * sigmoidf_(go));
        y[(size_t)t * D + c] = sigmoidf_(pr[C_MA + c]) * ya[(size_t)t * D + c] + sigmoidf_(pr[C_MB + c]) * yb; }
}
__device__ __forceinline__ float block_sum_256(float v, float* red) {
#pragma unroll
    for (int m = 1; m < 64; m <<= 1) v += __shfl_xor(v, m);
    __syncthreads();
    if ((threadIdx.x & 63) == 0) red[threadIdx.x >> 6] = v;
    __syncthreads();
    return red[0] + red[1] + red[2] + red[3];
}
__global__ void __launch_bounds__(256) k_ln(const float* res, const float* add, const float* g, const float* bta, float* out) {
    __shared__ float red[4];
    const int t = blockIdx.x, tid = threadIdx.x; float v[4]; float s = 0.f;
#pragma unroll
    for (int q = 0; q < 4; ++q) { const size_t i = (size_t)t * D + tid * 4 + q; v[q] = ALPHA * res[i] + add[i]; s += v[q]; }
    const float mean = block_sum_256(s, red) * (1.f / D); float s2 = 0.f;
#pragma unroll
    for (int q = 0; q < 4; ++q) { v[q] -= mean; s2 += v[q] * v[q]; }
    const float rstd = rsqrtf(block_sum_256(s2, red) * (1.f / D) + 1e-5f);
#pragma unroll
    for (int q = 0; q < 4; ++q) { const int c = tid * 4 + q; out[(size_t)t * D + c] = v[q] * rstd * g[c] + bta[c]; }
}
__global__ void k_route(const float* logits, int* cnt, int* list, int* tok_e, int* tok_pos, float* tok_g) {
    const int t = blockIdx.x * blockDim.x + threadIdx.x; if (t >= T) return;
    float l[NE];
#pragma unroll
    for (int e = 0; e < NE; ++e) l[e] = logits[(size_t)t * NE + e];
    int idx[4]; float val[4];
#pragma unroll
    for (int k = 0; k < 4; ++k) { int bi = 0; float bv = -INFINITY;
#pragma unroll
        for (int e = 0; e < NE; ++e) if (l[e] > bv) { bv = l[e]; bi = e; }
        idx[k] = bi; val[k] = bv;
#pragma unroll
        for (int e = 0; e < NE; ++e) if (e == bi) l[e] = -INFINITY; }
    float ex[4], sum = 0.f;
#pragma unroll
    for (int k = 0; k < 4; ++k) { ex[k] = expf(val[k] - val[0]); sum += ex[k]; }
#pragma unroll
    for (int k = 0; k < 4; ++k) { const int pos = atomicAdd(&cnt[idx[k]], 1); list[idx[k] * T + pos] = t * 4 + k;
        tok_e[t * 4 + k] = idx[k]; tok_pos[t * 4 + k] = pos; tok_g[t * 4 + k] = ex[k] / sum; }
}
__global__ void k_zero(int* p, int n) { const int i = blockIdx.x * blockDim.x + threadIdx.x; if (i < n) p[i] = 0; }

__global__ void __launch_bounds__(256) k_moe_up(const float* hx, const float* wup, const float* bup, const int* cnt, const int* list, float* act) {
    __shared__ float As[TK][TM + 4];
    __shared__ float Bs[TK][TN + 4];
    __shared__ int ridx[TM];
    const int e = blockIdx.z, m0 = blockIdx.y * TM, n0 = blockIdx.x * TN;
    const int ce = cnt[e]; if (m0 >= ce) return;
    int base = 0; for (int q = 0; q < e; ++q) base += cnt[q];
    if (threadIdx.x < TM) { const int m = m0 + threadIdx.x; ridx[threadIdx.x] = list[e * T + (m < ce ? m : m0)] >> 2; }
    __syncthreads();
    float accg[4][4], accu[4][4];
    const float* B = wup + (size_t)e * D * 2 * DFF;
    gemm_core(hx, D, ridx - m0, ce, B, 2 * DFF, 2 * DFF, D, m0, n0, accg, As, Bs);
    gemm_core(hx, D, ridx - m0, ce, B, 2 * DFF, 2 * DFF, D, m0, n0 + DFF, accu, As, Bs);
    const int tx = threadIdx.x & 15, ty = threadIdx.x >> 4;
#pragma unroll
    for (int i = 0; i < 4; ++i) { const int m = m0 + ty * 4 + i; if (m >= ce) continue;
#pragma unroll
        for (int j = 0; j < 4; ++j) { const int n = n0 + tx * 4 + j;
            const float gh = fminf(accg[i][j] + bup[e * 2 * DFF + n], 7.f);
            const float uh = fminf(fmaxf(accu[i][j] + bup[e * 2 * DFF + DFF + n], -7.f), 7.f);
            act[(size_t)(base + m) * DFF + n] = (uh + 1.f) * gh * sigmoidf_(1.702f * gh); } }
}
__global__ void __launch_bounds__(256) k_moe_down(const float* act, const float* wdn, const float* bdn, const int* cnt, const int* list, const float* tok_g, float* contrib) {
    __shared__ float As[TK][TM + 4];
    __shared__ float Bs[TK][TN + 4];
    const int e = blockIdx.z, m0 = blockIdx.y * TM, n0 = blockIdx.x * TN;
    const int ce = cnt[e]; if (m0 >= ce) return;
    int base = 0; for (int q = 0; q < e; ++q) base += cnt[q];
    float acc[4][4];
    gemm_core(act + (size_t)base * DFF, DFF, nullptr, ce, wdn + (size_t)e * DFF * D, D, D, DFF, m0, n0, acc, As, Bs);
    const int tx = threadIdx.x & 15, ty = threadIdx.x >> 4;
#pragma unroll
    for (int i = 0; i < 4; ++i) { const int m = m0 + ty * 4 + i; if (m >= ce) continue;
        const float g = tok_g[list[e * T + m]];
#pragma unroll
        for (int j = 0; j < 4; ++j) { const int n = n0 + tx * 4 + j; contrib[(size_t)(base + m) * D + n] = (acc[i][j] + bdn[e * D + n]) * g; } }
}
__global__ void __launch_bounds__(256) k_msum(const float* contrib, const int* cnt, const int* tok_e, const int* tok_pos, float* m) {
    __shared__ int base[NE];
    if (threadIdx.x == 0) { int s = 0; for (int e = 0; e < NE; ++e) { base[e] = s; s += cnt[e]; } }
    __syncthreads();
    const int t = blockIdx.x;
    float acc[4] = {0.f, 0.f, 0.f, 0.f};
    for (int k = 0; k < 4; ++k) { const int slot = base[tok_e[t * 4 + k]] + tok_pos[t * 4 + k];
#pragma unroll
        for (int q = 0; q < 4; ++q) acc[q] += contrib[(size_t)slot * D + threadIdx.x * 4 + q]; }
#pragma unroll
    for (int q = 0; q < 4; ++q) m[(size_t)t * D + threadIdx.x * 4 + q] = acc[q];
}
__global__ void k_final(const float* h2, const float* Gp, const float* Pl, float* out) {
    const size_t i = (size_t)blockIdx.x * blockDim.x + threadIdx.x; if (i >= (size_t)T * D) return;
    out[i] = h2[i] + sigmoidf_(Gp[i]) * Pl[i];
}
__global__ void k_scale_add(const float* x, float* z) {
}

extern "C" void kernel_launch(void* const* d_in, const int* in_sizes, int n_in, void* d_out, int out_size, void* d_ws, size_t ws_size, hipStream_t stream) {
    const float* x = (const float*)d_in[0]; const float* p = (const float*)d_in[1]; const float* w_in = (const float*)d_in[2];
    const float* conv_w = (const float*)d_in[3]; const float* conv_b = (const float*)d_in[4];
    const float* w_r = (const float*)d_in[5]; const float* b_r = (const float*)d_in[6]; const float* w_i = (const float*)d_in[7]; const float* b_i = (const float*)d_in[8];
    const float* lam = (const float*)d_in[9]; const float* wgate = (const float*)d_in[10]; const float* bgate = (const float*)d_in[11]; const float* ng = (const float*)d_in[12];
    const float* w_out = (const float*)d_in[13]; const float* ln1g = (const float*)d_in[14]; const float* ln1b = (const float*)d_in[15];
    const float* w_router = (const float*)d_in[16]; const float* b_router = (const float*)d_in[17];
    const float* w_up = (const float*)d_in[18]; const float* b_up = (const float*)d_in[19]; const float* w_dn = (const float*)d_in[20]; const float* b_dn = (const float*)d_in[21];
    const float* ln2g = (const float*)d_in[22]; const float* ln2b = (const float*)d_in[23];
    const float* w_ple = (const float*)d_in[24]; const float* w_pg = (const float*)d_in[25]; const float* b_pg = (const float*)d_in[26];
    float* out = (float*)d_out;
    char* ws = (char*)d_ws;
    const size_t MiB = 1ull << 20;
    float* proj = (float*)(ws + 0);
    float* act = (float*)(ws + 0);
    float* Gp = (float*)(ws + 256 * MiB);
    float* Pl = (float*)(ws + 320 * MiB);
    float* xc = (float*)(ws + 449 * MiB); float* rpre = (float*)(ws + 513 * MiB); float* ipre = (float*)(ws + 577 * MiB); float* ya = (float*)(ws + 641 * MiB);
    float* contrib = (float*)(ws + 449 * MiB);
    float* Gc = (float*)(ws + 705 * MiB);
    float* o = (float*)(ws + 737 * MiB);
    float* y = (float*)(ws + 801 * MiB);
    float* z = (float*)(ws + 865 * MiB);
    float* h = (float*)(ws + 929 * MiB);
    float* h2 = (float*)(ws + 705 * MiB);
    float* msum = (float*)(ws + 769 * MiB);
    float* logits = (float*)(ws + 993 * MiB);
    int* list = (int*)(ws + 996 * MiB);
    int* tok_e = (int*)(ws + 999 * MiB); int* tok_pos = (int*)(ws + 1000 * MiB); float* tok_g = (float*)(ws + 1001 * MiB); int* cnt = (int*)(ws + 1002 * MiB);
    if (ws_size < 1003 * MiB) { fprintf(stderr, "ws too small %zu\n", ws_size); return; }

    k_gemm<<<dim3((INT + TN - 1) / TN, T / TM), 256, 0, stream>>>(x, D, w_in, INT, proj, INT, T, INT, D, nullptr);
    k_conv<<<(T * D) / 256, 256, 0, stream>>>(proj, conv_w, conv_b, xc);
    for (int g = 0; g < 8; ++g) {
        k_gemm<<<dim3(2, T / TM), 256, 0, stream>>>(xc + g * 128, D, w_r + (size_t)g * 128 * 128, 128, rpre + g * 128, D, T, 128, 128, nullptr);
        k_gemm<<<dim3(2, T / TM), 256, 0, stream>>>(xc + g * 128, D, w_i + (size_t)g * 128 * 128, 128, ipre + g * 128, D, T, 128, 128, nullptr);
    }
    k_scan<<<(BATCH * D) / 64, 64, 0, stream>>>(proj, xc, rpre, ipre, b_r, b_i, lam, ya);
    k_logg<<<T / GCH, 512, 0, stream>>>(proj, wgate, bgate, Gc);
    {
        const size_t sm = (size_t)(64 * 129 * 2 + 64 * GW + 64 * 65 + 128 * 33 + 128) * 4;
        static bool attr = false; if (!attr) { hipFuncSetAttribute((const void*)k_gla, hipFuncAttributeMaxDynamicSharedMemorySize, (int)sm); attr = true; }
        k_gla<<<BATCH * GH * 8, 256, sm, stream>>>(proj, Gc, o);
    }
    k_ycomb<<<T, 256, 0, stream>>>(proj, ya, o, ng, y);
    k_gemm<<<dim3(D / TN, T / TM), 256, 0, stream>>>(y, D, w_out, D, z, D, T, D, D, nullptr);
    k_ln<<<T, 256, 0, stream>>>(x, z, ln1g, ln1b, h);
    k_gemm<<<dim3(1, T / TM), 256, 0, stream>>>(h, D, w_router, NE, logits, NE, T, NE, D, b_router);
    k_zero<<<1, 64, 0, stream>>>(cnt, NE);
    k_route<<<T / 256, 256, 0, stream>>>(logits, cnt, list, tok_e, tok_pos, tok_g);
    k_moe_up<<<dim3(DFF / TN, T / TM, NE), 256, 0, stream>>>(h, w_up, b_up, cnt, list, act);
    k_moe_down<<<dim3(D / TN, T / TM, NE), 256, 0, stream>>>(act, w_dn, b_dn, cnt, list, tok_g, contrib);
    k_msum<<<T, 256, 0, stream>>>(contrib, cnt, tok_e, tok_pos, msum);
    k_ln<<<T, 256, 0, stream>>>(h, msum, ln2g, ln2b, h2);
    k_gemm<<<dim3(D / TN, T / TM), 256, 0, stream>>>(h2, D, w_pg, D, Gp, D, T, D, D, b_pg);
    k_gemm<<<dim3(D / TN, T / TM), 256, 0, stream>>>(p, PLE, w_ple, D, Pl, D, T, D, PLE, nullptr);
    k_final<<<(T * D) / 256, 256, 0, stream>>>(h2, Gp, Pl, out);
}
```
